# Optimizing an MI355X kernel written in HIP

```python
import jax, jax.numpy as jnp
from jax import lax
import numpy as np

D_MODEL = 2048
BATCH = 4
SEQ = 2048
DEPTH = 2
DEC_BATCH = 128
DEC_SEQ = 1
PAST_LEN = 16384
PAGE_SIZE = 128

D_MIX = D_MODEL
D_HGRN = D_MIX // 2
HGRN_DK = 128
HGRN_DV = 128
HGRN_HEADS = D_HGRN // HGRN_DV
D_FORGET = HGRN_HEADS * HGRN_DK
D_POOL = D_MIX - D_HGRN
POOL_WINDOWS = (2, 4, 8, 16)
N_POOL = len(POOL_WINDOWS)
D_PG = D_POOL // N_POOL
POOL_BUF = max(POOL_WINDOWS) - 1
D_IN = 2 * D_FORGET + 2 * D_HGRN + D_POOL
D_FF = -(-(8 * D_MODEL) // (3 * 256)) * 256
PLE_DIM = 256
CHUNK = 16
EPS = 1e-6

kernel_name = "hymba_hgrn2_multiscale_pool_decoder"


def _rmsnorm(x, g):
    xf = x.astype(jnp.float32)
    y = xf * lax.rsqrt(jnp.mean(xf * xf, axis=-1, keepdims=True) + EPS)
    return (y * g.astype(jnp.float32)).astype(x.dtype)


def _hgrn2_chunked(q, k, v, log_f, S0):
    B, T, H, _ = q.shape
    C = min(CHUNK, T)
    n = -(-T // C)
    pad = n * C - T
    if pad:
        pz = ((0, 0), (0, pad), (0, 0), (0, 0))
        q, k, v, log_f = (jnp.pad(a, pz) for a in (q, k, v, log_f))

    def to_chunks(a):
        return a.reshape(B, n, C, H, a.shape[-1]).transpose(1, 0, 3, 2, 4)

    qc, kc, vc, gc = (to_chunks(a) for a in (q, k, v, log_f))
    mask = jnp.tril(jnp.ones((C, C), dtype=bool))[:, :, None]

    def step(S, inp):
        qb, kb, vb, gb = inp
        b = jnp.cumsum(gb, axis=-2)
        diff = b[..., :, None, :] - b[..., None, :, :]
        decay = jnp.exp(jnp.where(mask, diff, -jnp.inf))
        A = jnp.einsum('bhtd,bhsd,bhtsd->bhts', qb, kb, decay)
        o = (jnp.einsum('bhts,bhsv->bhtv', A, vb)
             + jnp.einsum('bhtd,bhdv->bhtv', qb * jnp.exp(b), S))
        bl = b[..., -1:, :]
        S_new = (jnp.exp(bl[..., 0, :])[..., None] * S
                 + jnp.einsum('bhsd,bhsv->bhdv', kb * jnp.exp(bl - b), vb))
        return S_new, o

    S, o = lax.scan(step, S0, (qc, kc, vc, gc))
    o = o.transpose(1, 0, 3, 2, 4).reshape(B, n * C, H, -1)[:, :T]
    return o, S


def _multiscale_pool(u, buf, start_pos):
    B, T, _ = u.shape
    ext = jnp.concatenate([buf.astype(u.dtype), u], axis=1)
    cs = jnp.cumsum(ext.astype(jnp.float32), axis=1)
    cs = jnp.pad(cs, ((0, 0), (1, 0), (0, 0)))
    pos = start_pos + jnp.arange(T)
    outs = []
    for gi, w in enumerate(POOL_WINDOWS):
        lo, hi = gi * D_PG, (gi + 1) * D_PG
        s = cs[:, POOL_BUF + 1:POOL_BUF + 1 + T, lo:hi] - cs[:, POOL_BUF + 1 - w:POOL_BUF + 1 - w + T, lo:hi]
        cnt = jnp.minimum(pos + 1, w).astype(jnp.float32)
        outs.append(s / cnt[None, :, None])
    mean = jnp.concatenate(outs, axis=-1)
    return mean - u.astype(jnp.float32), ext[:, -POOL_BUF:]


def _layer(h, p_l, S0, buf, start_pos, lb, g_mix, w_in, g_head, w_pool, pool_scale, w_out,
           g_ffn, w_gate_up, w_down, w_ple, g_ple, w_ple_gate):
    B, T, _ = h.shape
    n1 = _rmsnorm(h, g_mix)
    proj = n1 @ w_in
    o1, o2, o3, o4 = D_FORGET, 2 * D_FORGET, 2 * D_FORGET + D_HGRN, 2 * D_FORGET + 2 * D_HGRN
    q_raw, f_raw, v, g_raw, u = proj[..., :o1], proj[..., o1:o2], proj[..., o2:o3], proj[..., o3:o4], proj[..., o4:]

    q = jax.nn.silu(q_raw.astype(jnp.float32)) * (HGRN_DK ** -0.5)
    fg = lb + (1.0 - lb) * jax.nn.sigmoid(f_raw.astype(jnp.float32))
    k = 1.0 - fg
    log_f = jnp.log(fg)
    def heads(a, d):
        return a.reshape(B, T, HGRN_HEADS, d)
    o, S_new = _hgrn2_chunked(heads(q, HGRN_DK), heads(k, HGRN_DK), heads(v.astype(jnp.float32), HGRN_DV),
                              heads(log_f, HGRN_DK), S0.astype(jnp.float32))
    o = _rmsnorm(o, g_head).reshape(B, T, D_HGRN) * jax.nn.silu(g_raw.astype(jnp.float32))

    pooled, buf_new = _multiscale_pool(u, buf, start_pos)
    pm = jnp.einsum('btgc,gcd->btgd', pooled.reshape(B, T, N_POOL, D_PG), w_pool.astype(jnp.float32))
    pm = pm.reshape(B, T, D_POOL) * pool_scale.astype(jnp.float32)

    mix = jnp.concatenate([o, pm], axis=-1).astype(h.dtype)
    h = h + mix @ w_out

    gu = _rmsnorm(h, g_ffn) @ w_gate_up
    h = h + (jax.nn.silu(gu[..., :D_FF]) * gu[..., D_FF:]) @ w_down

    e = _rmsnorm(p_l @ w_ple, g_ple)
    h = h + jax.nn.sigmoid(h @ w_ple_gate) * e
    return h, S_new, buf_new


def _trunk(h, p, S_all, buf_all, start_pos, lbs, g_mix, w_in, g_head, w_pool, pool_scale, w_out,
           g_ffn, w_gate_up, w_down, w_ple, g_ple, w_ple_gate, g_final):
    S_out, buf_out = [], []
    for i in range(DEPTH):
        h, S_i, b_i = _layer(h, p[i], S_all[i], buf_all[i], start_pos, lbs[i], g_mix[i], w_in[i], g_head[i],
                             w_pool[i], pool_scale[i], w_out[i], g_ffn[i], w_gate_up[i], w_down[i],
                             w_ple[i], g_ple[i], w_ple_gate[i])
        S_out.append(S_i)
        buf_out.append(b_i)
    return _rmsnorm(h, g_final), jnp.stack(S_out), jnp.stack(buf_out)


def setup_inputs(seed: int = 0) -> dict:
    key = jax.random.key(seed)
    ks = jax.random.split(key, 20)
    f32 = jnp.float32
    def nrm(k, shape, scale):
        return jax.random.normal(k, shape, f32) * scale
    def gain(k, shape):
        return 1.0 + 0.02 * jax.random.normal(k, shape, f32)
    return {
        'x_prompt': nrm(ks[0], (BATCH, SEQ, D_MODEL), 1.0),
        'x_sample': nrm(ks[1], (DEC_BATCH, DEC_SEQ, D_MODEL), 1.0),
        'state_hgrn': nrm(ks[2], (DEPTH, DEC_BATCH, HGRN_HEADS, HGRN_DK, HGRN_DV), 0.5),
        'state_pool': nrm(ks[3], (DEPTH, DEC_BATCH, POOL_BUF, D_POOL), 1.0),
        'p_prompt': nrm(ks[4], (DEPTH, BATCH, SEQ, PLE_DIM), 1.0),
        'p_sample': nrm(ks[5], (DEPTH, DEC_BATCH, DEC_SEQ, PLE_DIM), 1.0),
        'g_mix': gain(ks[6], (DEPTH, D_MODEL)),
        'w_in': nrm(ks[7], (DEPTH, D_MODEL, D_IN), D_MODEL ** -0.5),
        'lb_logits': nrm(ks[8], (DEPTH, D_FORGET), 0.5),
        'g_head': gain(ks[9], (DEPTH, HGRN_DV)),
        'w_pool': nrm(ks[10], (DEPTH, N_POOL, D_PG, D_PG), D_PG ** -0.5),
        'pool_scale': gain(ks[11], (DEPTH, D_POOL)),
        'w_out': nrm(ks[12], (DEPTH, D_MIX, D_MODEL), D_MIX ** -0.5),
        'g_ffn': gain(ks[13], (DEPTH, D_MODEL)),
        'w_gate_up': nrm(ks[14], (DEPTH, D_MODEL, 2 * D_FF), D_MODEL ** -0.5),
        'w_down': nrm(ks[15], (DEPTH, D_FF, D_MODEL), D_FF ** -0.5),
        'w_ple': nrm(ks[16], (DEPTH, PLE_DIM, D_MODEL), PLE_DIM ** -0.5),
        'g_ple': gain(ks[17], (DEPTH, D_MODEL)),
        'w_ple_gate': nrm(ks[18], (DEPTH, D_MODEL, D_MODEL), D_MODEL ** -0.5),
        'g_final': gain(ks[19], (D_MODEL,)),
    }


def reference(x_prompt, x_sample, state_hgrn, state_pool, p_prompt, p_sample, g_mix, w_in, lb_logits,
              g_head, w_pool, pool_scale, w_out, g_ffn, w_gate_up, w_down, w_ple, g_ple, w_ple_gate, g_final):
    lbs = jnp.cumsum(jax.nn.softmax(lb_logits.astype(jnp.float32), axis=0), axis=0)
    lbs = lbs - lbs[:1]
    weights = (g_mix, w_in, g_head, w_pool, pool_scale, w_out, g_ffn, w_gate_up, w_down,
               w_ple, g_ple, w_ple_gate, g_final)
    S0 = jnp.zeros((DEPTH, BATCH, HGRN_HEADS, HGRN_DK, HGRN_DV), jnp.float32)
    b0 = jnp.zeros((DEPTH, BATCH, POOL_BUF, D_POOL), x_prompt.dtype)
    y_prompt, new_hgrn_prompt, new_pool_prompt = _trunk(x_prompt, p_prompt, S0, b0, 0, lbs, *weights)
    y_sample, new_hgrn_sample, new_pool_sample = _trunk(x_sample, p_sample, state_hgrn, state_pool,
                                                        PAST_LEN, lbs, *weights)
    return (y_prompt, y_sample, new_hgrn_prompt, new_pool_prompt, new_hgrn_sample, new_pool_sample)
```

```cpp
#include <hip/hip_runtime.h>
#include <hip/hip_cooperative_groups.h>
#include <cstdio>
namespace cg = cooperative_groups;

#define LAS __attribute__((address_space(3)))
typedef unsigned short bf16_t;
typedef short bf16x8 __attribute__((ext_vector_type(8)));
typedef float f32x4 __attribute__((ext_vector_type(4)));
typedef unsigned u32x4 __attribute__((ext_vector_type(4)));
typedef unsigned u32x2 __attribute__((ext_vector_type(2)));

constexpr int DM = 2048, SEQ = 2048, NBATCH = 4, DEPTH = 2, DECB = 128;
constexpr int MPROMPT = NBATCH * SEQ, MREAL = MPROMPT + DECB, MP = 8448;
constexpr int DIN = 5120, DFF = 5632, PLE = 256, NH = 8, DPOOL = 1024, POOLBUF = 15;
constexpr int NCH = 32, CL = 64;
constexpr float EPS = 1e-6f;

constexpr size_t A256(size_t x) { return (x + 255) & ~(size_t)255; }
constexpr size_t SZ_WT_IN = (size_t)DIN * DM * 2, SZ_WT_OUT = (size_t)DM * DM * 2, SZ_WT_GU = (size_t)2 * DFF * DM * 2, SZ_WT_DOWN = (size_t)DM * DFF * 2,
                 SZ_WT_PLE = (size_t)DM * PLE * 2, SZ_WT_PG = (size_t)DM * DM * 2, SZ_WT_POOL = (size_t)4 * 256 * 256 * 2;
constexpr size_t O_WT_IN = 0;
constexpr size_t O_WT_OUT = O_WT_IN + 2 * SZ_WT_IN;
constexpr size_t O_WT_GU = O_WT_OUT + 2 * SZ_WT_OUT;
constexpr size_t O_WT_DOWN = O_WT_GU + 2 * SZ_WT_GU;
constexpr size_t O_WT_PLE = O_WT_DOWN + 2 * SZ_WT_DOWN;
constexpr size_t O_WT_PG = O_WT_PLE + 2 * SZ_WT_PLE;
constexpr size_t O_WT_POOL = O_WT_PG + 2 * SZ_WT_PG;
constexpr size_t O_H = O_WT_POOL + 2 * SZ_WT_POOL;
constexpr size_t O_HB0 = O_H + (size_t)MP * DM * 4;
constexpr size_t O_HB1 = O_HB0 + (size_t)MP * DM * 2;
constexpr size_t O_PB = O_HB1 + (size_t)MP * DM * 2;
constexpr size_t O_Q = O_PB + (size_t)2 * MP * PLE * 2;
constexpr size_t O_LOGF = O_Q + (size_t)MP * 1024 * 2;
constexpr size_t O_V = O_LOGF + (size_t)MP * 1024 * 4;
constexpr size_t O_GATE = O_V + (size_t)MP * 1024 * 2;
constexpr size_t O_U = O_GATE + (size_t)MP * 1024 * 2;
constexpr size_t O_POOLED = O_U + (size_t)MP * 1024 * 4;
constexpr size_t O_MIX = O_POOLED + (size_t)MP * 1024 * 2;
constexpr size_t O_ERAW = O_MIX + (size_t)MP * DM * 2;
constexpr size_t O_ACT = O_ERAW + (size_t)MP * DM * 2;
constexpr size_t O_UT = O_ACT;
constexpr size_t O_SBUF = O_UT + (size_t)1024 * 16384 * 4;
constexpr size_t SZ_ACTREG = (size_t)1024 * 16384 * 6;
static_assert(SZ_ACTREG >= (size_t)MP * DFF * 2, "act alias");
constexpr size_t O_GBUF = O_ACT + SZ_ACTREG;
constexpr size_t O_SS = O_GBUF + (size_t)1024 * 128 * 4;
constexpr size_t O_LBS = O_SS + (size_t)8 * MP * 4;
constexpr size_t WS_END = O_LBS + 2 * 1024 * 4;

constexpr size_t OUT_Y = 0;
constexpr size_t OUT_HGRN_P = (size_t)MREAL * DM;
constexpr size_t OUT_POOL_P = OUT_HGRN_P + (size_t)DEPTH * NBATCH * NH * 16384;
constexpr size_t OUT_HGRN_S = OUT_POOL_P + (size_t)DEPTH * NBATCH * POOLBUF * DPOOL;
constexpr size_t OUT_POOL_S = OUT_HGRN_S + (size_t)DEPTH * DECB * NH * 16384;

struct Params {
    const float* x_prompt; const float* x_sample; const float* state_hgrn; const float* state_pool; const float* p_prompt; const float* p_sample;
    const float* g_mix; const float* w_in; const float* lb_logits; const float* g_head; const float* w_pool; const float* pool_scale; const float* w_out;
    const float* g_ffn; const float* w_gate_up; const float* w_down; const float* w_ple; const float* g_ple; const float* w_ple_gate; const float* g_final;
    float* out; unsigned char* ws;
    int ph_lo, ph_hi, coop, pad_;
};

__device__ __forceinline__ int tid_opaque() { int t = threadIdx.x; asm volatile("" : "+v"(t)); return t; }
__device__ __forceinline__ float bf2f(bf16_t b) { return __uint_as_float(((unsigned)b) << 16); }
__device__ __forceinline__ unsigned cvt_pk_bf16(float lo, float hi) { unsigned r; asm volatile("v_cvt_pk_bf16_f32 %0, %1, %2" : "=v"(r) : "v"(lo), "v"(hi)); return r; }
__device__ __forceinline__ float sigmoidf_(float x) { return 1.0f / (1.0f + __expf(-x)); }
__device__ __forceinline__ float siluf_(float x) { return x / (1.0f + __expf(-x)); }
__device__ __forceinline__ u32x4 pack8(const f32x4& a, const f32x4& b) { u32x4 w; w.x = cvt_pk_bf16(a[0], a[1]); w.y = cvt_pk_bf16(a[2], a[3]); w.z = cvt_pk_bf16(b[0], b[1]); w.w = cvt_pk_bf16(b[2], b[3]); return w; }
__device__ __forceinline__ void unpack8(const u32x4& w, f32x4& a, f32x4& b) {
    a[0] = __uint_as_float(w.x << 16); a[1] = __uint_as_float(w.x & 0xffff0000u); a[2] = __uint_as_float(w.y << 16); a[3] = __uint_as_float(w.y & 0xffff0000u);
    b[0] = __uint_as_float(w.z << 16); b[1] = __uint_as_float(w.z & 0xffff0000u); b[2] = __uint_as_float(w.w << 16); b[3] = __uint_as_float(w.w & 0xffff0000u); }

constexpr int BM = 256, BK = 64, HALF = 128, HTB = HALF * BK * 2, STAGE_BYTES = 8 * HTB, NXCD = 8, WGM = 8;
__device__ __forceinline__ int lds_byte(int r, int c) { const int st = (r >> 4) * 2 + (c >> 5), rr = r & 15, cc = c & 31, ob = rr * 64 + cc * 2; return st * 1024 + (ob ^ (((ob >> 9) & 1) << 5)); }
__device__ __forceinline__ void stage_rc(int b, int& R, int& C) { const int st = b / 1024, sb = b % 1024, swz = sb ^ (((sb >> 9) & 1) << 5); R = (st >> 1) * 16 + swz / 64; C = (st & 1) * 32 + (swz % 64) / 2; }
__device__ __forceinline__ int perm32(int rho) { const int n = rho >> 4, i = rho & 15; return 8 * (i >> 2) + 4 * n + (i & 3); }

struct Unit { int pm, pn; };
struct Gemm { const bf16_t* A; const bf16_t* Bt; int M, N, K, lda, ldb; size_t a_pn_step; };
struct StaticOrder {
    int nM, nN, nwg, G, c;
    __device__ void init(int M, int N, int G_, int c_) { nM = M / BM; nN = N / BM; nwg = nM * nN; G = G_; c = c_; }
    __device__ bool next(int i, Unit& u) const {
        const long L = (long)i * G + c; if (L >= nwg) return false;
        int wgid = (int)L; { const int q = nwg / NXCD, r = nwg % NXCD, xcd = wgid % NXCD, off = wgid / NXCD; wgid = (xcd < r ? xcd * (q + 1) : r * (q + 1) + (xcd - r) * q) + off; }
        const int nig = WGM * nN, gid = wgid / nig, fm = gid * WGM, gsz = (nM - fm) < WGM ? (nM - fm) : WGM;
        u.pm = fm + ((wgid % nig) % gsz); u.pn = (wgid % nig) / gsz; return true;
    }
};

template <class Epi>
__device__ __forceinline__ void gemm_phase(LAS unsigned char* lds, const Gemm g, const StaticOrder& S, const Epi& E) {
    const int tid = tid_opaque(), wid = __builtin_amdgcn_readfirstlane(tid >> 6), lane = tid & 63, wr = wid >> 2, wc = wid & 3, fr = lane & 15, fq = lane >> 4;
    const int K = g.K, nt = K / BK;
    unsigned voffA[2], voffB[2];
#pragma unroll
    for (int i = 0; i < 2; ++i) { int R, C; stage_rc(tid * 16 + i * 8192, R, C); const int Rb = (R & ~31) + perm32(R & 31);
        voffA[i] = (unsigned)(R * g.lda + C) * 2u; voffB[i] = (unsigned)(Rb * g.ldb + C) * 2u; }
    const size_t kstep = (size_t)(BK * 2);
    const size_t hstepA = (size_t)HALF * g.lda * 2, hstepB = (size_t)HALF * g.ldb * 2;
    const size_t tstepA = 2 * hstepA, tstepB = 2 * hstepB;
    const unsigned ldsw = (unsigned)wid * 1024u;
    const int aoff = lds_byte(wr * 64 + fr, fq * 8), boff = lds_byte(wc * 32 + fr, fq * 8);
#define PG8_SA(b, h) (((b) * 2 + (h)) * HTB)
#define PG8_SB(b, h) ((4 + (b) * 2 + (h)) * HTB)
#define PG8_STAGE(bufoff, gbase, voff) do { _Pragma("unroll") for (int _i = 0; _i < 2; ++_i) \
        __builtin_amdgcn_global_load_lds((const unsigned*)((const char*)(gbase) + (voff)[_i]), (LAS unsigned*)(lds + (bufoff) + ldsw + _i * 8192), 16, 0, 0); } while (0)
#define PG8_LDA(dst, b, h) do { _Pragma("unroll") for (int m = 0; m < 4; ++m) _Pragma("unroll") for (int k = 0; k < 2; ++k) dst[m][k] = *(const LAS bf16x8*)(lds + PG8_SA(b, h) + aoff + m * 2048 + k * 1024); } while (0)
#define PG8_LDB(dst, b, h) do { _Pragma("unroll") for (int n = 0; n < 2; ++n) _Pragma("unroll") for (int k = 0; k < 2; ++k) dst[n][k] = *(const LAS bf16x8*)(lds + PG8_SB(b, h) + boff + n * 2048 + k * 1024); } while (0)
#define PG8_MMA(ai, bj, At, Bt) do { __builtin_amdgcn_s_setprio(1); _Pragma("unroll") for (int m = 0; m < 4; ++m) _Pragma("unroll") for (int n = 0; n < 2; ++n) _Pragma("unroll") for (int k = 0; k < 2; ++k) \
        acc[ai][bj][m][n] = __builtin_amdgcn_mfma_f32_16x16x32_bf16(Bt[n][k], At[m][k], acc[ai][bj][m][n], 0, 0, 0); __builtin_amdgcn_s_setprio(0); } while (0)
#define PG8_WAIT_V(n) asm volatile("s_waitcnt vmcnt(" #n ")" ::: "memory")
#define PG8_WAIT_L(n) asm volatile("s_waitcnt lgkmcnt(" #n ")" ::: "memory")
#define PG8_BAR __builtin_amdgcn_s_barrier()
#define PG8_SCHED __builtin_amdgcn_sched_barrier(0)
    Unit cur, nxt; int ui = 0;
    if (!S.next(0, cur)) return;
    f32x4 acc[2][2][4][2];
#pragma unroll
    for (int a = 0; a < 2; ++a)
#pragma unroll
        for (int b = 0; b < 2; ++b)
#pragma unroll
            for (int m = 0; m < 4; ++m)
#pragma unroll
                for (int n = 0; n < 2; ++n) acc[a][b][m][n] = (f32x4){0.f, 0.f, 0.f, 0.f};
    bf16x8 At[4][2], B0[2][2], B1[2][2];
    const char* cA = (const char*)g.A + (size_t)cur.pm * tstepA + (size_t)cur.pn * g.a_pn_step; const char* cB = (const char*)g.Bt + (size_t)cur.pn * tstepB;
    PG8_STAGE(PG8_SB(0, 0), cB, voffB); PG8_STAGE(PG8_SA(0, 0), cA, voffA); PG8_STAGE(PG8_SB(0, 1), cB + hstepB, voffB); PG8_STAGE(PG8_SA(0, 1), cA + hstepA, voffA);
    if (wr == 1) PG8_BAR;
    PG8_WAIT_V(4); PG8_BAR;
    PG8_STAGE(PG8_SB(1, 0), cB + kstep, voffB); PG8_STAGE(PG8_SA(1, 0), cA + kstep, voffA); PG8_STAGE(PG8_SB(1, 1), cB + hstepB + kstep, voffB);
    PG8_WAIT_V(6); PG8_BAR;
    for (;;) {
        const bool has_next = S.next(ui + 1, nxt);
        const char* nA = has_next ? (const char*)g.A + (size_t)nxt.pm * tstepA + (size_t)nxt.pn * g.a_pn_step : cA; const char* nB = has_next ? (const char*)g.Bt + (size_t)nxt.pn * tstepB : cB;
#pragma unroll 1
        for (int t = 0; t < nt; t += 2) {
            const bool last = (t == nt - 2);
            const char* a1 = cA + (size_t)(t + 1) * kstep;
            const char* a2 = last ? nA : cA + (size_t)(t + 2) * kstep; const char* b2 = last ? nB : cB + (size_t)(t + 2) * kstep;
            const char* a3 = a2 + kstep; const char* b3 = b2 + kstep;
            PG8_LDB(B0, 0, 0); PG8_SCHED; PG8_LDA(At, 0, 0); PG8_STAGE(PG8_SA(1, 1), a1 + hstepA, voffA);
            PG8_WAIT_L(8); PG8_BAR; PG8_WAIT_L(0); PG8_MMA(0, 0, At, B0); PG8_BAR; PG8_SCHED;
            PG8_LDB(B1, 0, 1); PG8_STAGE(PG8_SB(0, 0), b2, voffB);
            PG8_BAR; PG8_WAIT_L(0); PG8_MMA(0, 1, At, B1); PG8_BAR;
            PG8_LDA(At, 0, 1); PG8_STAGE(PG8_SA(0, 0), a2, voffA);
            PG8_BAR; PG8_WAIT_L(0); PG8_MMA(1, 0, At, B0); PG8_BAR; PG8_SCHED;
            PG8_STAGE(PG8_SB(0, 1), b2 + hstepB, voffB);
            PG8_WAIT_V(6); PG8_BAR; PG8_MMA(1, 1, At, B1); PG8_BAR;
            PG8_LDB(B0, 1, 0); PG8_SCHED; PG8_LDA(At, 1, 0); PG8_STAGE(PG8_SA(0, 1), a2 + hstepA, voffA);
            PG8_WAIT_L(8); PG8_BAR; PG8_WAIT_L(0); PG8_MMA(0, 0, At, B0); PG8_BAR; PG8_SCHED;
            PG8_LDB(B1, 1, 1); PG8_STAGE(PG8_SB(1, 0), b3, voffB);
            PG8_BAR; PG8_WAIT_L(0); PG8_MMA(0, 1, At, B1); PG8_BAR;
            PG8_LDA(At, 1, 1); PG8_STAGE(PG8_SA(1, 0), a3, voffA);
            PG8_BAR; PG8_WAIT_L(0); PG8_MMA(1, 0, At, B0); PG8_BAR; PG8_SCHED;
            PG8_STAGE(PG8_SB(1, 1), b3 + hstepB, voffB);
            PG8_WAIT_V(6); PG8_BAR; PG8_MMA(1, 1, At, B1); PG8_BAR;
        }
        E(acc, cur, wr, wc, fr, fq);
        if (!has_next) break;
#pragma unroll
        for (int a = 0; a < 2; ++a)
#pragma unroll
            for (int b = 0; b < 2; ++b)
#pragma unroll
                for (int m = 0; m < 4; ++m)
#pragma unroll
                    for (int n = 0; n < 2; ++n) acc[a][b][m][n] = (f32x4){0.f, 0.f, 0.f, 0.f};
        cur = nxt; cA = nA; cB = nB; ++ui;
    }
    PG8_WAIT_V(0);
    if (wr == 0) PG8_BAR;
    PG8_BAR;
#undef PG8_SA
#undef PG8_SB
#undef PG8_STAGE
#undef PG8_LDA
#undef PG8_LDB
#undef PG8_MMA
#undef PG8_WAIT_V
#undef PG8_WAIT_L
#undef PG8_BAR
#undef PG8_SCHED
}

__device__ __forceinline__ void row_atomic_add(float* dst, float v, int fq) {
    v += __shfl_xor(v, 16); v += __shfl_xor(v, 32);
    if (fq == 0) atomicAdd(dst, v);
}

struct Epi1 {
    const float* ss; bf16_t* q; float* logf; bf16_t* v; bf16_t* gate; float* u; const float* lb;
    __device__ __forceinline__ void operator()(const f32x4 (&acc)[2][2][4][2], const Unit& un, int wr, int wc, int fr, int fq) const {
        const int seg = un.pn >> 2, colt = (un.pn & 3) * 256;
        const int row0 = un.pm * BM + wr * 64 + fr, col0 = colt + wc * 32 + 8 * fq;
#pragma unroll
        for (int ai = 0; ai < 2; ++ai)
#pragma unroll
            for (int m = 0; m < 4; ++m) {
                const int r = row0 + ai * HALF + m * 16;
                const float rstd = rsqrtf(ss[r] * (1.0f / DM) + EPS);
#pragma unroll
                for (int bj = 0; bj < 2; ++bj) {
                    const int c = col0 + bj * HALF; const size_t o = (size_t)r * 1024 + c;
                    f32x4 v0 = acc[ai][bj][m][0] * rstd, v1 = acc[ai][bj][m][1] * rstd;
                    if (seg == 0) {
#pragma unroll
                        for (int j = 0; j < 4; ++j) { v0[j] = siluf_(v0[j]) * 0.08838834764831845f; v1[j] = siluf_(v1[j]) * 0.08838834764831845f; }
                        *(u32x4*)(q + o) = pack8(v0, v1);
                    } else if (seg == 1) {
                        const f32x4 l0 = *(const f32x4*)(lb + c), l1 = *(const f32x4*)(lb + c + 4);
#pragma unroll
                        for (int j = 0; j < 4; ++j) { v0[j] = __logf(l0[j] + (1.0f - l0[j]) * sigmoidf_(v0[j])); v1[j] = __logf(l1[j] + (1.0f - l1[j]) * sigmoidf_(v1[j])); }
                        *(f32x4*)(logf + o) = v0; *(f32x4*)(logf + o + 4) = v1;
                    } else if (seg == 2) {
                        *(u32x4*)(v + o) = pack8(v0, v1);
                    } else if (seg == 3) {
#pragma unroll
                        for (int j = 0; j < 4; ++j) { v0[j] = siluf_(v0[j]); v1[j] = siluf_(v1[j]); }
                        *(u32x4*)(gate + o) = pack8(v0, v1);
                    } else {
                        *(f32x4*)(u + o) = v0; *(f32x4*)(u + o + 4) = v1;
                    }
                }
            }
    }
};

struct EpiE {
    bf16_t* e; float* ss;
    __device__ __forceinline__ void operator()(const f32x4 (&acc)[2][2][4][2], const Unit& un, int wr, int wc, int fr, int fq) const {
        const int row0 = un.pm * BM + wr * 64 + fr, col0 = un.pn * BM + wc * 32 + 8 * fq;
#pragma unroll
        for (int ai = 0; ai < 2; ++ai)
#pragma unroll
            for (int m = 0; m < 4; ++m) {
                const int r = row0 + ai * HALF + m * 16; float sq = 0.f;
#pragma unroll
                for (int bj = 0; bj < 2; ++bj) {
                    const f32x4 v0 = acc[ai][bj][m][0], v1 = acc[ai][bj][m][1];
#pragma unroll
                    for (int j = 0; j < 4; ++j) sq += v0[j] * v0[j] + v1[j] * v1[j];
                    *(u32x4*)(e + (size_t)r * DM + col0 + bj * HALF) = pack8(v0, v1);
                }
                row_atomic_add(ss + r, sq, fq);
            }
    }
};

struct EpiRes {
    float* h; bf16_t* hb; float* ss;
    __device__ __forceinline__ void operator()(const f32x4 (&acc)[2][2][4][2], const Unit& un, int wr, int wc, int fr, int fq) const {
        const int row0 = un.pm * BM + wr * 64 + fr, col0 = un.pn * BM + wc * 32 + 8 * fq;
#pragma unroll
        for (int ai = 0; ai < 2; ++ai)
#pragma unroll
            for (int m = 0; m < 4; ++m) {
                const int r = row0 + ai * HALF + m * 16; float sq = 0.f;
#pragma unroll
                for (int bj = 0; bj < 2; ++bj) {
                    const size_t o = (size_t)r * DM + col0 + bj * HALF;
                    const f32x4 v0 = *(const f32x4*)(h + o) + acc[ai][bj][m][0], v1 = *(const f32x4*)(h + o + 4) + acc[ai][bj][m][1];
#pragma unroll
                    for (int j = 0; j < 4; ++j) sq += v0[j] * v0[j] + v1[j] * v1[j];
                    *(f32x4*)(h + o) = v0; *(f32x4*)(h + o + 4) = v1;
                    *(u32x4*)(hb + o) = pack8(v0, v1);
                }
                if (ss) row_atomic_add(ss + r, sq, fq);
            }
    }
};

struct Epi3 {
    const float* ss; bf16_t* act;
    __device__ __forceinline__ void operator()(const f32x4 (&acc)[2][2][4][2], const Unit& un, int wr, int wc, int fr, int fq) const {
        const int row0 = un.pm * BM + wr * 64 + fr, col0 = un.pn * HALF + wc * 32 + 8 * fq;
#pragma unroll
        for (int ai = 0; ai < 2; ++ai)
#pragma unroll
            for (int m = 0; m < 4; ++m) {
                const int r = row0 + ai * HALF + m * 16;
                const float rstd = rsqrtf(ss[r] * (1.0f / DM) + EPS);
                f32x4 g0 = acc[ai][0][m][0] * rstd, g1 = acc[ai][0][m][1] * rstd; const f32x4 u0 = acc[ai][1][m][0] * rstd, u1 = acc[ai][1][m][1] * rstd;
#pragma unroll
                for (int j = 0; j < 4; ++j) { g0[j] = siluf_(g0[j]) * u0[j]; g1[j] = siluf_(g1[j]) * u1[j]; }
                *(u32x4*)(act + (size_t)r * DFF + col0) = pack8(g0, g1);
            }
    }
};

struct Epi5 {
    float* h; bf16_t* hb; float* ss; const bf16_t* e; const float* sse; const float* gple;
    __device__ __forceinline__ void operator()(const f32x4 (&acc)[2][2][4][2], const Unit& un, int wr, int wc, int fr, int fq) const {
        const int row0 = un.pm * BM + wr * 64 + fr, col0 = un.pn * BM + wc * 32 + 8 * fq;
#pragma unroll
        for (int ai = 0; ai < 2; ++ai)
#pragma unroll
            for (int m = 0; m < 4; ++m) {
                const int r = row0 + ai * HALF + m * 16; float sq = 0.f;
                const float rse = rsqrtf(sse[r] * (1.0f / DM) + EPS);
#pragma unroll
                for (int bj = 0; bj < 2; ++bj) {
                    const int c = col0 + bj * HALF; const size_t o = (size_t)r * DM + c;
                    f32x4 e0, e1; unpack8(*(const u32x4*)(e + o), e0, e1);
                    const f32x4 gp0 = *(const f32x4*)(gple + c), gp1 = *(const f32x4*)(gple + c + 4);
                    f32x4 v0 = *(const f32x4*)(h + o), v1 = *(const f32x4*)(h + o + 4);
                    const f32x4 a0 = acc[ai][bj][m][0], a1 = acc[ai][bj][m][1];
#pragma unroll
                    for (int j = 0; j < 4; ++j) { v0[j] += sigmoidf_(a0[j]) * (e0[j] * rse * gp0[j]); v1[j] += sigmoidf_(a1[j]) * (e1[j] * rse * gp1[j]); sq += v0[j] * v0[j] + v1[j] * v1[j]; }
                    *(f32x4*)(h + o) = v0; *(f32x4*)(h + o + 4) = v1;
                    *(u32x4*)(hb + o) = pack8(v0, v1);
                }
                row_atomic_add(ss + r, sq, fq);
            }
    }
};

struct EpiPool {
    bf16_t* mix; const float* scale;
    __device__ __forceinline__ void operator()(const f32x4 (&acc)[2][2][4][2], const Unit& un, int wr, int wc, int fr, int fq) const {
        const int row0 = un.pm * BM + wr * 64 + fr, col0 = un.pn * BM + wc * 32 + 8 * fq;
#pragma unroll
        for (int ai = 0; ai < 2; ++ai)
#pragma unroll
            for (int m = 0; m < 4; ++m) {
                const int r = row0 + ai * HALF + m * 16;
#pragma unroll
                for (int bj = 0; bj < 2; ++bj) {
                    const int c = col0 + bj * HALF;
                    const f32x4 s0 = *(const f32x4*)(scale + c), s1 = *(const f32x4*)(scale + c + 4);
                    *(u32x4*)(mix + (size_t)r * DM + 1024 + c) = pack8(acc[ai][bj][m][0] * s0, acc[ai][bj][m][1] * s1);
                }
            }
    }
};

__device__ __forceinline__ void tc_tile(LAS float* tile, const float* __restrict__ src, int K, int N, bf16_t* __restrict__ dst, const float* __restrict__ g, int mode, int t) {
    const int ntn = N >> 6, tk = t / ntn, tn = t - tk * ntn, k0 = tk << 6, n0 = tn << 6, tid = tid_opaque();
#pragma unroll
    for (int i = 0; i < 2; ++i) { const int idx = tid + i * 512, kr = idx >> 4, c4 = idx & 15;
        const f32x4 x = *(const f32x4*)(src + (size_t)(k0 + kr) * N + n0 + c4 * 4);
        const float s = g ? g[k0 + kr] : 1.0f;
#pragma unroll
        for (int j = 0; j < 4; ++j) tile[kr * 65 + c4 * 4 + j] = x[j] * s; }
    __syncthreads();
    { const int n = tid >> 3, kg = tid & 7; float x[8];
#pragma unroll
        for (int i = 0; i < 8; ++i) x[i] = tile[(kg * 8 + i) * 65 + n];
        int nn = n0 + n;
        if (mode == 1) { nn = (nn < DFF) ? ((nn >> 7) * 256 + (nn & 127)) : ((((nn - DFF) >> 7) * 256) + 128 + ((nn - DFF) & 127)); }
        u32x4 w; w.x = cvt_pk_bf16(x[0], x[1]); w.y = cvt_pk_bf16(x[2], x[3]); w.z = cvt_pk_bf16(x[4], x[5]); w.w = cvt_pk_bf16(x[6], x[7]);
        *(u32x4*)(dst + (size_t)nn * K + k0 + kg * 8) = w; }
    __syncthreads();
}
__device__ __forceinline__ void tc_matrix(LAS float* tile, const float* src, int K, int N, bf16_t* dst, const float* g, int mode, int rot) {
    const int ntiles = (K >> 6) * (N >> 6);
    for (int t = (int)((blockIdx.x + (unsigned)rot) % gridDim.x); t < ntiles; t += gridDim.x) tc_tile(tile, src, K, N, dst, g, mode, t);
}

__device__ void phase_prologue(const Params& P, LAS unsigned char* lds) {
    unsigned char* ws = P.ws;
    const int tid = tid_opaque(), wid = tid >> 6, lane = tid & 63;
    const size_t gtid = (size_t)blockIdx.x * 512 + tid, gsz = (size_t)gridDim.x * 512;
    { float* h = (float*)(ws + O_H); bf16_t* hb = (bf16_t*)(ws + O_HB0); float* ss0 = (float*)(ws + O_SS);
      for (int r = blockIdx.x * 8 + wid; r < MREAL; r += gridDim.x * 8) {
          const float* src = r < MPROMPT ? P.x_prompt + (size_t)r * DM : P.x_sample + (size_t)(r - MPROMPT) * DM; float sq = 0.f;
#pragma unroll
          for (int it = 0; it < 8; ++it) { const int c = it * 256 + lane * 4; const f32x4 x = *(const f32x4*)(src + c);
              sq += x[0] * x[0] + x[1] * x[1] + x[2] * x[2] + x[3] * x[3];
              *(f32x4*)(h + (size_t)r * DM + c) = x; u32x2 w; w.x = cvt_pk_bf16(x[0], x[1]); w.y = cvt_pk_bf16(x[2], x[3]); *(u32x2*)(hb + (size_t)r * DM + c) = w; }
#pragma unroll
          for (int o = 32; o > 0; o >>= 1) sq += __shfl_xor(sq, o);
          if (lane == 0) ss0[r] = sq; } }
    { bf16_t* pb = (bf16_t*)(ws + O_PB);
      for (size_t i = gtid; i < (size_t)2 * MREAL * 64; i += gsz) { const int l = (int)(i / ((size_t)MREAL * 64)); const size_t rem = i - (size_t)l * MREAL * 64; const int r = (int)(rem >> 6), c = (int)(rem & 63) * 4;
          const float* src = r < MPROMPT ? P.p_prompt + ((size_t)l * MPROMPT + r) * PLE + c : P.p_sample + ((size_t)l * DECB + (r - MPROMPT)) * PLE + c;
          const f32x4 x = *(const f32x4*)src; u32x2 w; w.x = cvt_pk_bf16(x[0], x[1]); w.y = cvt_pk_bf16(x[2], x[3]); *(u32x2*)(pb + ((size_t)l * MP + r) * PLE + c) = w; } }
    { const u32x4 z = (u32x4){0u, 0u, 0u, 0u}; const int PADR = MP - MREAL;
      u32x4* a = (u32x4*)(ws + O_H + (size_t)MREAL * DM * 4); for (size_t i = gtid; i < (size_t)PADR * DM * 4 / 16; i += gsz) a[i] = z;
      a = (u32x4*)(ws + O_HB0 + (size_t)MREAL * DM * 2); for (size_t i = gtid; i < (size_t)PADR * DM * 2 / 16; i += gsz) a[i] = z;
      a = (u32x4*)(ws + O_MIX + (size_t)MREAL * DM * 2); for (size_t i = gtid; i < (size_t)PADR * DM * 2 / 16; i += gsz) a[i] = z;
      a = (u32x4*)(ws + O_POOLED + (size_t)MREAL * 1024 * 2); for (size_t i = gtid; i < (size_t)PADR * 1024 * 2 / 16; i += gsz) a[i] = z;
      for (int l = 0; l < 2; ++l) { a = (u32x4*)(ws + O_PB + ((size_t)l * MP + MREAL) * PLE * 2); for (size_t i = gtid; i < (size_t)PADR * PLE * 2 / 16; i += gsz) a[i] = z; }
      float* ss = (float*)(ws + O_SS); for (size_t i = gtid; i < (size_t)7 * MP; i += gsz) ss[MP + i] = 0.f;
      for (size_t i = gtid; i < (size_t)(MP - MREAL); i += gsz) ss[MREAL + i] = 0.f;
      float* lbs = (float*)(ws + O_LBS); for (size_t i = gtid; i < 1024; i += gsz) { lbs[i] = 0.f; lbs[1024 + i] = 1.0f / (1.0f + __expf(P.lb_logits[i] - P.lb_logits[1024 + i])); } }
    LAS float* tile = (LAS float*)lds;
    for (int l = 0; l < DEPTH; ++l) {
        tc_matrix(tile, P.w_in + (size_t)l * DM * DIN, DM, DIN, (bf16_t*)(ws + O_WT_IN + l * SZ_WT_IN), P.g_mix + l * DM, 0, 0);
        tc_matrix(tile, P.w_out + (size_t)l * DM * DM, DM, DM, (bf16_t*)(ws + O_WT_OUT + l * SZ_WT_OUT), nullptr, 0, 0);
        tc_matrix(tile, P.w_gate_up + (size_t)l * DM * 2 * DFF, DM, 2 * DFF, (bf16_t*)(ws + O_WT_GU + l * SZ_WT_GU), P.g_ffn + l * DM, 1, 0);
        tc_matrix(tile, P.w_down + (size_t)l * DFF * DM, DFF, DM, (bf16_t*)(ws + O_WT_DOWN + l * SZ_WT_DOWN), nullptr, 0, 0);
        tc_matrix(tile, P.w_ple + (size_t)l * PLE * DM, PLE, DM, (bf16_t*)(ws + O_WT_PLE + l * SZ_WT_PLE), nullptr, 0, 0);
        tc_matrix(tile, P.w_ple_gate + (size_t)l * DM * DM, DM, DM, (bf16_t*)(ws + O_WT_PG + l * SZ_WT_PG), nullptr, 0, 128);
        for (int gq = 0; gq < 4; ++gq)
            tc_matrix(tile, P.w_pool + ((size_t)l * 4 + gq) * 65536, 256, 256, (bf16_t*)(ws + O_WT_POOL + l * SZ_WT_POOL) + (size_t)gq * 65536, nullptr, 0, 16 * (l * 4 + gq) + 64);
    }
}

__device__ void m1_item(const Params& P, LAS unsigned char* lds, int item) {
    unsigned char* ws = P.ws;
    const int c = item & 31, bh = item >> 5, h = bh & 7, b = bh >> 3, r0 = b * SEQ + c * CL;
    const int tid = tid_opaque(), d = tid & 127, seg = tid >> 7, wid = tid >> 6, lane = tid & 63, l16 = lane & 15, l4 = lane >> 4;
    LAS bf16_t* KT = (LAS bf16_t*)lds; LAS bf16_t* VT = KT + 128 * 72; LAS float* tot = (LAS float*)(lds + 2 * 128 * 72 * 2);
    const float* lf = (const float*)(ws + O_LOGF) + (size_t)(r0 + seg * 16) * 1024 + h * 128 + d;
    const bf16_t* vp = (const bf16_t*)(ws + O_V) + (size_t)(r0 + seg * 16) * 1024 + h * 128 + d;
    float p[16], k[16]; float run = 0.f; unsigned vw[8];
#pragma unroll
    for (int i = 0; i < 16; ++i) { const float x = lf[(size_t)i * 1024]; k[i] = -expm1f(x); run += x; p[i] = run; }
    tot[seg * 128 + d] = run;
#pragma unroll
    for (int i = 0; i < 8; ++i) vw[i] = (unsigned)vp[(size_t)(2 * i) * 1024] | ((unsigned)vp[(size_t)(2 * i + 1) * 1024] << 16);
    *(LAS u32x4*)(VT + d * 72 + seg * 16) = (u32x4){vw[0], vw[1], vw[2], vw[3]}; *(LAS u32x4*)(VT + d * 72 + seg * 16 + 8) = (u32x4){vw[4], vw[5], vw[6], vw[7]};
    __syncthreads();
    { const float t0 = tot[d], t1 = tot[128 + d], t2 = tot[256 + d], t3 = tot[384 + d];
      const float off = seg == 0 ? 0.f : (seg == 1 ? t0 : (seg == 2 ? t0 + t1 : t0 + t1 + t2)); const float bL = t0 + t1 + t2 + t3;
      unsigned kw[8];
#pragma unroll
      for (int i = 0; i < 8; ++i) kw[i] = cvt_pk_bf16(k[2 * i] * __expf(bL - (off + p[2 * i])), k[2 * i + 1] * __expf(bL - (off + p[2 * i + 1])));
      *(LAS u32x4*)(KT + d * 72 + seg * 16) = (u32x4){kw[0], kw[1], kw[2], kw[3]}; *(LAS u32x4*)(KT + d * 72 + seg * 16 + 8) = (u32x4){kw[4], kw[5], kw[6], kw[7]};
      if (seg == 0) ((float*)(ws + O_GBUF))[(size_t)item * 128 + d] = __expf(bL); }
    __syncthreads();
    { const bf16x8 a0 = *(const LAS bf16x8*)(KT + (wid * 16 + l16) * 72 + l4 * 8), a1 = *(const LAS bf16x8*)(KT + (wid * 16 + l16) * 72 + 32 + l4 * 8);
      float* ut = (float*)(ws + O_UT) + (size_t)item * 16384;
#pragma unroll
      for (int vt = 0; vt < 8; ++vt) {
          const bf16x8 b0 = *(const LAS bf16x8*)(VT + (vt * 16 + l16) * 72 + l4 * 8), b1 = *(const LAS bf16x8*)(VT + (vt * 16 + l16) * 72 + 32 + l4 * 8);
          f32x4 acc = (f32x4){0.f, 0.f, 0.f, 0.f};
          acc = __builtin_amdgcn_mfma_f32_16x16x32_bf16(a0, b0, acc, 0, 0, 0); acc = __builtin_amdgcn_mfma_f32_16x16x32_bf16(a1, b1, acc, 0, 0, 0);
          *(f32x4*)(ut + (size_t)(vt * 16 + l16) * 128 + wid * 16 + 4 * l4) = acc;
      } }
    __syncthreads();
}

__device__ void dec_item(const Params& P, LAS unsigned char* lds, int l, int item) {
    unsigned char* ws = P.ws;
    const int h = item & 7, b = item >> 3, r = MPROMPT + b, col0 = h * 128;
    const int tid = tid_opaque(), vq = tid & 31, dg = tid >> 5, v0 = vq * 4, d0 = dg * 8;
    LAS float* red = (LAS float*)lds; LAS float* red2 = red + 16 * 128;
    const float* lf = (const float*)(ws + O_LOGF) + (size_t)r * 1024 + col0; const bf16_t* qp = (const bf16_t*)(ws + O_Q) + (size_t)r * 1024 + col0;
    const bf16_t* vp = (const bf16_t*)(ws + O_V) + (size_t)r * 1024 + col0 + v0;
    const u32x2 vw = *(const u32x2*)vp; const f32x4 vv = (f32x4){__uint_as_float(vw.x << 16), __uint_as_float(vw.x & 0xffff0000u), __uint_as_float(vw.y << 16), __uint_as_float(vw.y & 0xffff0000u)};
    const size_t sb = ((((size_t)l * DECB + b) * NH + h) * 128) * 128;
    const float* s0 = P.state_hgrn + sb; float* sn = P.out + OUT_HGRN_S + sb;
    f32x4 o = (f32x4){0.f, 0.f, 0.f, 0.f};
#pragma unroll
    for (int i = 0; i < 8; ++i) { const int d = d0 + i; const float x = lf[d], f = __expf(x), k = -expm1f(x), qd = bf2f(qp[d]);
        const f32x4 S = *(const f32x4*)(s0 + (size_t)d * 128 + v0) * f + vv * k; *(f32x4*)(sn + (size_t)d * 128 + v0) = S; o += S * qd; }
    *(LAS f32x4*)(red + dg * 128 + v0) = o;
    __syncthreads();
    float ov = 0.f;
    if (tid < 128) {
#pragma unroll
        for (int i = 0; i < 16; ++i) ov += red[i * 128 + tid];
        float sq = ov * ov;
#pragma unroll
        for (int of = 32; of > 0; of >>= 1) sq += __shfl_xor(sq, of);
        if ((tid & 63) == 0) red2[tid >> 6] = sq; }
    __syncthreads();
    if (tid < 128) { const float rs = rsqrtf((red2[0] + red2[1]) * (1.0f / 128) + EPS);
        const float gt = bf2f(((const bf16_t*)(ws + O_GATE))[(size_t)r * 1024 + col0 + tid]);
        const float y = ov * rs * P.g_head[l * 128 + tid] * gt;
        ((bf16_t*)(ws + O_MIX))[(size_t)r * DM + col0 + tid] = (bf16_t)(cvt_pk_bf16(y, 0.f) & 0xffffu); }
    __syncthreads();
}

__device__ void pool_elem(const Params& P, int l) {
    unsigned char* ws = P.ws; const float* u = (const float*)(ws + O_U); bf16_t* pooled = (bf16_t*)(ws + O_POOLED);
    const size_t gtid = (size_t)blockIdx.x * 512 + tid_opaque(), gsz = (size_t)gridDim.x * 512;
    for (size_t i = gtid; i < (size_t)MREAL * 256; i += gsz) {
        const int r = (int)(i >> 8), c0 = (int)(i & 255) * 4, w = 2 << (c0 >> 8);
        const f32x4 ur = *(const f32x4*)(u + (size_t)r * 1024 + c0); f32x4 s = ur; float inv;
        if (r < MPROMPT) { const int t = r & (SEQ - 1), n = (t + 1 < w) ? t + 1 : w;
            for (int j = 1; j < n; ++j) s += *(const f32x4*)(u + (size_t)(r - j) * 1024 + c0);
            inv = 1.0f / (float)n;
            if (t >= SEQ - POOLBUF) *(f32x4*)(P.out + OUT_POOL_P + (((size_t)l * NBATCH + (r >> 11)) * POOLBUF + (t - (SEQ - POOLBUF))) * DPOOL + c0) = ur;
        } else { const int b = r - MPROMPT; const float* sp = P.state_pool + ((size_t)l * DECB + b) * POOLBUF * DPOOL + c0;
            for (int j = 16 - w; j < POOLBUF; ++j) s += *(const f32x4*)(sp + (size_t)j * DPOOL);
            inv = 1.0f / (float)w;
            float* op = P.out + OUT_POOL_S + ((size_t)l * DECB + b) * POOLBUF * DPOOL + c0;
            for (int j = 0; j < POOLBUF - 1; ++j) *(f32x4*)(op + (size_t)j * DPOOL) = *(const f32x4*)(sp + (size_t)(j + 1) * DPOOL);
            *(f32x4*)(op + (size_t)(POOLBUF - 1) * DPOOL) = ur; }
        const f32x4 pv = s * inv - ur; u32x2 wv; wv.x = cvt_pk_bf16(pv[0], pv[1]); wv.y = cvt_pk_bf16(pv[2], pv[3]);
        *(u32x2*)(pooled + (size_t)r * 1024 + c0) = wv; }
}

__device__ void phase_scan(const Params& P, int l) {
    unsigned char* ws = P.ws; const float* ut = (const float*)(ws + O_UT); const float* gb = (const float*)(ws + O_GBUF); bf16_t* sbuf = (bf16_t*)(ws + O_SBUF);
    for (size_t g = (size_t)blockIdx.x * 512 + tid_opaque(); g < (size_t)32 * 4096; g += (size_t)gridDim.x * 512) {
        const int bh = (int)(g >> 12), e4 = (int)(g & 4095), v = e4 >> 5, d0 = (e4 & 31) * 4;
        f32x4 S = (f32x4){0.f, 0.f, 0.f, 0.f};
#pragma unroll 4
        for (int c = 0; c < NCH; ++c) { const size_t item = (size_t)bh * NCH + c;
            u32x2 w; w.x = cvt_pk_bf16(S[0], S[1]); w.y = cvt_pk_bf16(S[2], S[3]); *(u32x2*)(sbuf + item * 16384 + v * 128 + d0) = w;
            const f32x4 G = *(const f32x4*)(gb + item * 128 + d0), U = *(const f32x4*)(ut + item * 16384 + v * 128 + d0);
            S = G * S + U; }
        float* o = P.out + OUT_HGRN_P + (((size_t)l * 32 + bh) * 128 + d0) * 128 + v;
        o[0] = S[0]; o[128] = S[1]; o[256] = S[2]; o[384] = S[3]; }
}

constexpr int M3_BF = 0, M3_Q1 = 34816, M3_Q2 = M3_Q1 + 17408, M3_K2 = M3_Q2 + 17408, M3_VT = M3_K2 + 17408, M3_PM = M3_VT + 18432, M3_TOT = M3_PM + 9216, M3_RED = M3_TOT + 2048;
__device__ void m3_item(const Params& P, LAS unsigned char* lds, int l, int item) {
    unsigned char* ws = P.ws;
    const int c = item & 31, bh = item >> 5, h = bh & 7, b = bh >> 3, r0 = b * SEQ + c * CL;
    const int tid = tid_opaque(), wid = tid >> 6, lane = tid & 63, l16 = lane & 15, l4 = lane >> 4;
    LAS float* BF = (LAS float*)(lds + M3_BF); LAS bf16_t* ST = (LAS bf16_t*)(lds + M3_BF);
    LAS bf16_t* Q1 = (LAS bf16_t*)(lds + M3_Q1); LAS bf16_t* Q2 = (LAS bf16_t*)(lds + M3_Q2); LAS bf16_t* K2 = (LAS bf16_t*)(lds + M3_K2);
    LAS bf16_t* VT = (LAS bf16_t*)(lds + M3_VT); LAS bf16_t* PM = (LAS bf16_t*)(lds + M3_PM); LAS float* tot = (LAS float*)(lds + M3_TOT); LAS float* red = (LAS float*)(lds + M3_RED);
    const float* logf = (const float*)(ws + O_LOGF);
    {
        const int d = tid & 127, seg = tid >> 7;
        const float* lf = logf + (size_t)(r0 + seg * 16) * 1024 + h * 128 + d;
        const bf16_t* vp = (const bf16_t*)(ws + O_V) + (size_t)(r0 + seg * 16) * 1024 + h * 128 + d;
        float p[16]; float run = 0.f; unsigned vw[8];
#pragma unroll
        for (int i = 0; i < 16; ++i) { run += lf[(size_t)i * 1024]; p[i] = run; }
        tot[seg * 128 + d] = run;
#pragma unroll
        for (int i = 0; i < 8; ++i) vw[i] = (unsigned)vp[(size_t)(2 * i) * 1024] | ((unsigned)vp[(size_t)(2 * i + 1) * 1024] << 16);
        *(LAS u32x4*)(VT + d * 72 + seg * 16) = (u32x4){vw[0], vw[1], vw[2], vw[3]}; *(LAS u32x4*)(VT + d * 72 + seg * 16 + 8) = (u32x4){vw[4], vw[5], vw[6], vw[7]};
        __syncthreads();
        const float t0 = tot[d], t1 = tot[128 + d], t2 = tot[256 + d];
        const float off = seg == 0 ? 0.f : (seg == 1 ? t0 : (seg == 2 ? t0 + t1 : t0 + t1 + t2));
#pragma unroll
        for (int i = 0; i < 16; ++i) BF[(seg * 16 + i) * 128 + d] = off + p[i];
    }
    __syncthreads();
    {
        const int s = tid >> 3, d0 = (tid & 7) * 16; const size_t go = (size_t)(r0 + s) * 1024 + h * 128 + d0;
        const bf16_t* qp = (const bf16_t*)(ws + O_Q) + go;
#pragma unroll
        for (int half = 0; half < 2; ++half) {
            const int dd = d0 + half * 8;
            f32x4 q0, q1; unpack8(*(const u32x4*)(qp + half * 8), q0, q1);
            f32x4 a0, a1, b0, b1, c0, c1;
#pragma unroll
            for (int part = 0; part < 2; ++part) {
                const int de = dd + part * 4;
                const f32x4 bb = *(const LAS f32x4*)(BF + s * 128 + de), bm = *(const LAS f32x4*)(tot + de) + *(const LAS f32x4*)(tot + 128 + de);
                const f32x4 lfv = *(const f32x4*)(logf + go + half * 8 + part * 4); const f32x4 qq = part == 0 ? q0 : q1;
                f32x4 x1, x2, x3;
#pragma unroll
                for (int j = 0; j < 4; ++j) { const float kk = -expm1f(lfv[j]); x1[j] = qq[j] * __expf(bb[j]); x2[j] = qq[j] * __expf(bb[j] - bm[j]); x3[j] = kk * __expf(bm[j] - bb[j]); }
                if (part == 0) { a0 = x1; b0 = x2; c0 = x3; } else { a1 = x1; b1 = x2; c1 = x3; }
            }
            *(LAS u32x4*)(Q1 + s * 136 + dd) = pack8(a0, a1); *(LAS u32x4*)(Q2 + s * 136 + dd) = pack8(b0, b1); *(LAS u32x4*)(K2 + s * 136 + dd) = pack8(c0, c1);
        }
    }
    __syncthreads();
    {
        const bf16_t* sb = (const bf16_t*)(ws + O_SBUF) + (size_t)item * 16384;
#pragma unroll
        for (int i = 0; i < 4; ++i) { const int idx = tid + i * 512, v = idx >> 4, ch = idx & 15; *(LAS u32x4*)(ST + v * 136 + ch * 8) = *(const u32x4*)(sb + v * 128 + ch * 8); }
        const int tt = wid & 3;
#pragma unroll
        for (int si = 0; si < 2; ++si) { const int st = (wid >> 2) * 2 + si;
            f32x4 acc = (f32x4){0.f, 0.f, 0.f, 0.f};
            if (st <= tt) {
#pragma unroll
                for (int kk = 0; kk < 4; ++kk) { const bf16x8 a = *(const LAS bf16x8*)(K2 + (st * 16 + l16) * 136 + kk * 32 + l4 * 8), bq = *(const LAS bf16x8*)(Q2 + (tt * 16 + l16) * 136 + kk * 32 + l4 * 8);
                    acc = __builtin_amdgcn_mfma_f32_16x16x32_bf16(a, bq, acc, 0, 0, 0); }
                const int t = tt * 16 + l16, s0 = st * 16 + 4 * l4;
#pragma unroll
                for (int j = 0; j < 4; ++j) if (s0 + j > t) acc[j] = 0.f;
            }
            u32x2 w; w.x = cvt_pk_bf16(acc[0], acc[1]); w.y = cvt_pk_bf16(acc[2], acc[3]);
            *(LAS u32x2*)(PM + (tt * 16 + l16) * 72 + st * 16 + 4 * l4) = w; }
    }
    __syncthreads();
    {
        const int tt = wid & 3, vh = wid >> 2;
        bf16x8 pb[2], qb[4];
#pragma unroll
        for (int kk = 0; kk < 2; ++kk) pb[kk] = *(const LAS bf16x8*)(PM + (tt * 16 + l16) * 72 + kk * 32 + l4 * 8);
#pragma unroll
        for (int kk = 0; kk < 4; ++kk) qb[kk] = *(const LAS bf16x8*)(Q1 + (tt * 16 + l16) * 136 + kk * 32 + l4 * 8);
        f32x4 o[4]; float sq = 0.f;
#pragma unroll
        for (int vi = 0; vi < 4; ++vi) { const int vt = vh * 4 + vi; f32x4 acc = (f32x4){0.f, 0.f, 0.f, 0.f};
#pragma unroll
            for (int kk = 0; kk < 2; ++kk) acc = __builtin_amdgcn_mfma_f32_16x16x32_bf16(*(const LAS bf16x8*)(VT + (vt * 16 + l16) * 72 + kk * 32 + l4 * 8), pb[kk], acc, 0, 0, 0);
#pragma unroll
            for (int kk = 0; kk < 4; ++kk) acc = __builtin_amdgcn_mfma_f32_16x16x32_bf16(*(const LAS bf16x8*)(ST + (vt * 16 + l16) * 136 + kk * 32 + l4 * 8), qb[kk], acc, 0, 0, 0);
            o[vi] = acc; sq += acc[0] * acc[0] + acc[1] * acc[1] + acc[2] * acc[2] + acc[3] * acc[3]; }
        sq += __shfl_xor(sq, 16); sq += __shfl_xor(sq, 32);
        if (l4 == 0) red[(tt * 16 + l16) * 2 + vh] = sq;
        __syncthreads();
        const int t = tt * 16 + l16; const float rs = rsqrtf((red[t * 2] + red[t * 2 + 1]) * (1.0f / 128) + EPS);
        const size_t rowo = (size_t)(r0 + t);
#pragma unroll
        for (int vi = 0; vi < 4; ++vi) { const int v = (vh * 4 + vi) * 16 + 4 * l4;
            const u32x2 gw = *(const u32x2*)((const bf16_t*)(ws + O_GATE) + rowo * 1024 + h * 128 + v);
            const f32x4 gh = *(const f32x4*)(P.g_head + l * 128 + v);
            const float y0 = o[vi][0] * rs * gh[0] * __uint_as_float(gw.x << 16), y1 = o[vi][1] * rs * gh[1] * __uint_as_float(gw.x & 0xffff0000u),
                        y2 = o[vi][2] * rs * gh[2] * __uint_as_float(gw.y << 16), y3 = o[vi][3] * rs * gh[3] * __uint_as_float(gw.y & 0xffff0000u);
            u32x2 w; w.x = cvt_pk_bf16(y0, y1); w.y = cvt_pk_bf16(y2, y3);
            *(u32x2*)((bf16_t*)(ws + O_MIX) + rowo * DM + h * 128 + v) = w; }
    }
    __syncthreads();
}

__device__ void phase_final(const Params& P) {
    const float* h = (const float*)(P.ws + O_H); const float* ss = (const float*)(P.ws + O_SS) + (size_t)6 * MP;
    for (size_t i = (size_t)blockIdx.x * 512 + tid_opaque(); i < (size_t)MREAL * 512; i += (size_t)gridDim.x * 512) {
        const int r = (int)(i >> 9), c = (int)(i & 511) * 4; const float rs = rsqrtf(ss[r] * (1.0f / DM) + EPS);
        const f32x4 x = *(const f32x4*)(h + (size_t)r * DM + c), g = *(const f32x4*)(P.g_final + c);
        *(f32x4*)(P.out + OUT_Y + (size_t)r * DM + c) = x * rs * g; }
}

constexpr int NPHASE = 1 + 8 * DEPTH + 1;
__global__ void __launch_bounds__(512, 2) mega(Params P) {
    extern __shared__ __attribute__((aligned(16))) unsigned char shm_raw[];
    LAS unsigned char* lds = (LAS unsigned char*)shm_raw;
    unsigned char* ws = P.ws;
    const int G = gridDim.x, bid = blockIdx.x;
    for (int ph = P.ph_lo; ph < P.ph_hi; ++ph) {
        if (ph > P.ph_lo) { if (P.coop) cg::this_grid().sync(); }
        if (ph == 0) { phase_prologue(P, lds); continue; }
        if (ph == NPHASE - 1) { phase_final(P); continue; }
        const int l = (ph - 1) >> 3, sub = (ph - 1) & 7;
        float* SS = (float*)(ws + O_SS);
        float* ss_in = SS + (size_t)(3 * l) * MP; float* ss_mid = SS + (size_t)(3 * l + 1) * MP; float* ss_e = SS + (size_t)(3 * l + 2) * MP; float* ss_out = SS + (size_t)(3 * l + 3) * MP;
        bf16_t* hbA = (bf16_t*)(ws + (l == 0 ? O_HB0 : O_HB1));
        bf16_t* hbB = (bf16_t*)(ws + (l == 0 ? O_HB1 : O_HB0));
        float* hf = (float*)(ws + O_H);
        StaticOrder S;
        if (sub == 0) {
            { Gemm g{hbA, (const bf16_t*)(ws + O_WT_IN + l * SZ_WT_IN), MP, DIN, DM, DM, DM, 0};
              Epi1 E{ss_in, (bf16_t*)(ws + O_Q), (float*)(ws + O_LOGF), (bf16_t*)(ws + O_V), (bf16_t*)(ws + O_GATE), (float*)(ws + O_U), (const float*)(ws + O_LBS) + l * 1024};
              S.init(MP, DIN, G, bid); gemm_phase(lds, g, S, E); }
            __syncthreads();
            { Gemm g{(const bf16_t*)(ws + O_PB) + (size_t)l * MP * PLE, (const bf16_t*)(ws + O_WT_PLE + l * SZ_WT_PLE), MP, DM, PLE, PLE, PLE, 0};
              EpiE E{(bf16_t*)(ws + O_ERAW), ss_e};
              S.init(MP, DM, G, (bid + 148) % G); gemm_phase(lds, g, S, E); }
        } else if (sub == 1) {
            for (int it = bid; it < 2048; it += G) { if (it < 1024) m1_item(P, lds, it); else dec_item(P, lds, l, it - 1024); }
            pool_elem(P, l);
        } else if (sub == 2) {
            phase_scan(P, l);
        } else if (sub == 3) {
            for (int it = bid; it < 1024; it += G) m3_item(P, lds, l, it);
            __syncthreads();
            { Gemm g{(const bf16_t*)(ws + O_POOLED), (const bf16_t*)(ws + O_WT_POOL + l * SZ_WT_POOL), MP, 1024, 256, 1024, 256, (size_t)512};
              EpiPool E{(bf16_t*)(ws + O_MIX), P.pool_scale + l * DPOOL};
              S.init(MP, 1024, G, bid); gemm_phase(lds, g, S, E); }
        } else if (sub == 4) {
            Gemm g{(const bf16_t*)(ws + O_MIX), (const bf16_t*)(ws + O_WT_OUT + l * SZ_WT_OUT), MP, DM, DM, DM, DM, 0};
            EpiRes E{hf, hbB, ss_mid};
            S.init(MP, DM, G, bid); gemm_phase(lds, g, S, E);
        } else if (sub == 5) {
            Gemm g{hbB, (const bf16_t*)(ws + O_WT_GU + l * SZ_WT_GU), MP, 2 * DFF, DM, DM, DM, 0};
            Epi3 E{ss_mid, (bf16_t*)(ws + O_ACT)};
            S.init(MP, 2 * DFF, G, bid); gemm_phase(lds, g, S, E);
        } else if (sub == 6) {
            Gemm g{(const bf16_t*)(ws + O_ACT), (const bf16_t*)(ws + O_WT_DOWN + l * SZ_WT_DOWN), MP, DM, DFF, DFF, DFF, 0};
            EpiRes E{hf, hbA, nullptr};
            S.init(MP, DM, G, bid); gemm_phase(lds, g, S, E);
        } else {
            Gemm g{hbA, (const bf16_t*)(ws + O_WT_PG + l * SZ_WT_PG), MP, DM, DM, DM, DM, 0};
            Epi5 E{hf, hbB, ss_out, (const bf16_t*)(ws + O_ERAW), ss_e, P.g_ple + l * DM};
            S.init(MP, DM, G, bid); gemm_phase(lds, g, S, E);
        }
    }
}

constexpr int LDS_BYTES = STAGE_BYTES;
static_assert(M3_RED + 512 <= LDS_BYTES, "lds");

extern "C" void kernel_launch(void* const* d_in, const int* in_sizes, int n_in, void* d_out, int out_size, void* d_ws, size_t ws_size, hipStream_t stream) {
    static int grid = 0;
    if (!grid) {
        if (ws_size < WS_END) { fprintf(stderr, "kernel_launch: workspace too small: %zu < %zu\n", ws_size, (size_t)WS_END); grid = -1; return; }
        int dev = 0, cus = 0, per_cu = 0;
        hipGetDevice(&dev); hipDeviceGetAttribute(&cus, hipDeviceAttributeMultiprocessorCount, dev);
        hipFuncSetAttribute((const void*)mega, hipFuncAttributeMaxDynamicSharedMemorySize, LDS_BYTES);
        hipOccupancyMaxActiveBlocksPerMultiprocessor(&per_cu, (const void*)mega, 512, LDS_BYTES);
        if (per_cu < 1) per_cu = 1;
        grid = cus * 1;
        if (grid > 256) grid = 256;
    }
    if (grid < 0) return;
    Params p{};
    p.x_prompt = (const float*)d_in[0]; p.x_sample = (const float*)d_in[1]; p.state_hgrn = (const float*)d_in[2]; p.state_pool = (const float*)d_in[3];
    p.p_prompt = (const float*)d_in[4]; p.p_sample = (const float*)d_in[5]; p.g_mix = (const float*)d_in[6]; p.w_in = (const float*)d_in[7];
    p.lb_logits = (const float*)d_in[8]; p.g_head = (const float*)d_in[9]; p.w_pool = (const float*)d_in[10]; p.pool_scale = (const float*)d_in[11];
    p.w_out = (const float*)d_in[12]; p.g_ffn = (const float*)d_in[13]; p.w_gate_up = (const float*)d_in[14]; p.w_down = (const float*)d_in[15];
    p.w_ple = (const float*)d_in[16]; p.g_ple = (const float*)d_in[17]; p.w_ple_gate = (const float*)d_in[18]; p.g_final = (const float*)d_in[19];
    p.out = (float*)d_out; p.ws = (unsigned char*)d_ws;
    p.ph_lo = 0; p.ph_hi = NPHASE; p.coop = 1; p.pad_ = 0;
    void* args[] = {&p};
    hipError_t e = hipLaunchCooperativeKernel((const void*)mega, dim3(grid), dim3(512), args, LDS_BYTES, stream);
    if (e != hipSuccess) fprintf(stderr, "cooperative launch failed: %s (grid %d)\n", hipGetErrorString(e), grid);
}
```
